# Optimizing an MI355X kernel written in HIP

```python
import math
import jax, jax.numpy as jnp
from jax import lax
import numpy as np

D_MODEL = 2048
BATCH = 4
SEQ = 2048
DEPTH = 4
DEC_BATCH = 32
DEC_SEQ = 4
PAST_LEN = 16384
PAGE_SIZE = 128

HEAD_DIM = 64
N_HEADS = 16
N_KV = 4
GROUP = N_HEADS // N_KV
D_Q = N_HEADS * HEAD_DIM
D_KV = N_KV * HEAD_DIM
WINDOW = 128
BLOCK = 128
ROPE_THETA = 10000.0
D_CONV = D_MODEL // 2
CONV_W = 3
D_FF = 5632
N_IN = D_Q + 2 * D_KV + 3 * D_CONV + 2 * D_MODEL
ALPHA = (2.0 * DEPTH) ** 0.25
BETA = (8.0 * DEPTH) ** -0.25
LN_EPS = 1e-5

kernel_name = "hybrid_swa_sink_shortconv_macaron_deepnorm_step"


def layer_norm(x, g, b):
    xf = x.astype(jnp.float32)
    mu = jnp.mean(xf, axis=-1, keepdims=True)
    var = jnp.mean(jnp.square(xf - mu), axis=-1, keepdims=True)
    y = (xf - mu) * lax.rsqrt(var + LN_EPS) * g.astype(jnp.float32) + b.astype(jnp.float32)
    return y.astype(x.dtype)


def swiglu(x, w_gu, w_down):
    g, u = jnp.split(x @ w_gu, 2, axis=-1)
    return (jax.nn.silu(g) * u) @ w_down


def rope(x, pos):
    inv_freq = ROPE_THETA ** (-jnp.arange(0, HEAD_DIM, 2, dtype=jnp.float32) / HEAD_DIM)
    ang = pos.astype(jnp.float32)[:, None] * inv_freq[None, :]
    cos = jnp.cos(ang)[None, :, None, :].astype(x.dtype)
    sin = jnp.sin(ang)[None, :, None, :].astype(x.dtype)
    x1, x2 = jnp.split(x, 2, axis=-1)
    return jnp.concatenate([x1 * cos - x2 * sin, x2 * cos + x1 * sin], axis=-1)


def sink_window_attention(q, k, v, q_pos, k_pos, sinks):
    s = jnp.einsum('bnqkgd,bnskd->bnkgqs', q, k).astype(jnp.float32) * (HEAD_DIM ** -0.5)
    diff = q_pos[:, :, None] - k_pos[:, None, :]
    mask = (diff >= 0) & (diff <= WINDOW) & (k_pos[:, None, :] >= 0)
    s = jnp.where(mask[None, :, None, None, :, :], s, -jnp.inf)
    sink = sinks.astype(jnp.float32).reshape(N_KV, GROUP)[None, None, :, :, None, None]
    sink = jnp.broadcast_to(sink, s.shape[:-1] + (1,))
    p = jax.nn.softmax(jnp.concatenate([s, sink], axis=-1), axis=-1)[..., :-1]
    return jnp.einsum('bnkgqs,bnskd->bnqkgd', p.astype(v.dtype), v)


def token_mix(x, past, w_in, sinks, conv_w, w_branch_attn, w_branch_conv, w_out):
    B, T, _ = x.shape
    cuts = np.cumsum([D_Q, D_KV, D_KV, D_CONV, D_CONV, D_CONV, D_MODEL]).tolist()
    q, k, v, cb, cc, ch, ga, gc = jnp.split(x @ w_in, cuts, axis=-1)
    q = q.reshape(B, T, N_HEADS, HEAD_DIM)
    k = k.reshape(B, T, N_KV, HEAD_DIM)
    v = v.reshape(B, T, N_KV, HEAD_DIM)
    offset = 0 if past is None else PAST_LEN
    pos = offset + jnp.arange(T, dtype=jnp.int32)
    q = rope(q, pos)
    k = rope(k, pos)
    u = cc * ch
    if past is None:
        nb = T // BLOCK
        qb = q.reshape(B, nb, BLOCK, N_KV, GROUP, HEAD_DIM)
        kb = k.reshape(B, nb, BLOCK, N_KV, HEAD_DIM)
        vb = v.reshape(B, nb, BLOCK, N_KV, HEAD_DIM)
        k_band = jnp.concatenate([jnp.concatenate([jnp.zeros_like(kb[:, :1]), kb[:, :-1]], 1), kb], 2)
        v_band = jnp.concatenate([jnp.concatenate([jnp.zeros_like(vb[:, :1]), vb[:, :-1]], 1), vb], 2)
        q_pos = pos.reshape(nb, BLOCK)
        k_pos = jnp.concatenate([q_pos - BLOCK, q_pos], axis=-1)
        attn = sink_window_attention(qb, k_band, v_band, q_pos, k_pos, sinks)
        new_k, new_v = k[:, -WINDOW:], v[:, -WINDOW:]
        u_pad = jnp.concatenate([jnp.zeros((B, CONV_W - 1, D_CONV), u.dtype), u], axis=1)
    else:
        k_past, v_past, conv_past = past
        k_all = jnp.concatenate([k_past, k], axis=1)
        v_all = jnp.concatenate([v_past, v], axis=1)
        q_pos = pos[None, :]
        k_pos = (PAST_LEN - WINDOW + jnp.arange(WINDOW + T, dtype=jnp.int32))[None, :]
        attn = sink_window_attention(q.reshape(B, 1, T, N_KV, GROUP, HEAD_DIM),
                                     k_all[:, None], v_all[:, None], q_pos, k_pos, sinks)
        new_k, new_v = k_all[:, -WINDOW:], v_all[:, -WINDOW:]
        u_pad = jnp.concatenate([conv_past, u], axis=1)
    attn = attn.reshape(B, T, D_Q)
    conv = sum(conv_w[j] * u_pad[:, j:j + T] for j in range(CONV_W))
    y_conv = cb * conv
    merged = jax.nn.sigmoid(ga) * (attn @ w_branch_attn) + jax.nn.sigmoid(gc) * (y_conv @ w_branch_conv)
    return merged @ w_out, new_k, new_v, u_pad[:, -(CONV_W - 1):]


def run_trunk(x, caches, ln_g, ln_b, w_in, sinks, conv_w, w_branch_attn, w_branch_conv, w_out,
              ffn1_gu, ffn1_down, ffn2_gu, ffn2_down):
    ks, vs, cs = [], [], []
    for l in range(DEPTH):
        past = None if caches is None else (caches[0][l], caches[1][l], caches[2][l])
        x = layer_norm(ALPHA * x + 0.5 * swiglu(x, ffn1_gu[l], ffn1_down[l]), ln_g[l, 0], ln_b[l, 0])
        m, nk, nv, nc = token_mix(x, past, w_in[l], sinks[l], conv_w[l],
                                  w_branch_attn[l], w_branch_conv[l], w_out[l])
        x = layer_norm(ALPHA * x + m, ln_g[l, 1], ln_b[l, 1])
        x = layer_norm(ALPHA * x + 0.5 * swiglu(x, ffn2_gu[l], ffn2_down[l]), ln_g[l, 2], ln_b[l, 2])
        ks.append(nk)
        vs.append(nv)
        cs.append(nc)
    return x, jnp.stack(ks), jnp.stack(vs), jnp.stack(cs)


def setup_inputs(seed: int = 0) -> dict:
    key = jax.random.key(seed)
    ks = jax.random.split(key, 20)
    f32 = jnp.float32
    nrm = lambda k, shape, scale: jax.random.normal(k, shape, f32) * scale
    return {
        "x_prompt": nrm(ks[0], (BATCH, SEQ, D_MODEL), 1.0),
        "x_sample": nrm(ks[1], (DEC_BATCH, DEC_SEQ, D_MODEL), 1.0),
        "cache_k_win": nrm(ks[2], (DEPTH, DEC_BATCH, WINDOW, N_KV, HEAD_DIM), 1.0),
        "cache_v_win": nrm(ks[3], (DEPTH, DEC_BATCH, WINDOW, N_KV, HEAD_DIM), 1.0),
        "state_conv": nrm(ks[4], (DEPTH, DEC_BATCH, CONV_W - 1, D_CONV), 1.0),
        "ln_g": 1.0 + nrm(ks[5], (DEPTH, 3, D_MODEL), 0.02),
        "ln_b": nrm(ks[6], (DEPTH, 3, D_MODEL), 0.02),
        "w_in": nrm(ks[7], (DEPTH, D_MODEL, N_IN), D_MODEL ** -0.5),
        "sinks": nrm(ks[8], (DEPTH, N_HEADS), 0.5),
        "conv_w": nrm(ks[9], (DEPTH, CONV_W, D_CONV), CONV_W ** -0.5),
        "w_branch_attn": nrm(ks[10], (DEPTH, D_Q, D_MODEL), D_Q ** -0.5),
        "w_branch_conv": nrm(ks[11], (DEPTH, D_CONV, D_MODEL), D_CONV ** -0.5),
        "w_out": nrm(ks[12], (DEPTH, D_MODEL, D_MODEL), BETA * D_MODEL ** -0.5),
        "ffn1_gu": nrm(ks[13], (DEPTH, D_MODEL, 2 * D_FF), D_MODEL ** -0.5),
        "ffn1_down": nrm(ks[14], (DEPTH, D_FF, D_MODEL), BETA * D_FF ** -0.5),
        "ffn2_gu": nrm(ks[15], (DEPTH, D_MODEL, 2 * D_FF), D_MODEL ** -0.5),
        "ffn2_down": nrm(ks[16], (DEPTH, D_FF, D_MODEL), BETA * D_FF ** -0.5),
    }


def reference(x_prompt, x_sample, cache_k_win, cache_v_win, state_conv, ln_g, ln_b, w_in, sinks,
              conv_w, w_branch_attn, w_branch_conv, w_out, ffn1_gu, ffn1_down, ffn2_gu, ffn2_down):
    y_prompt, k_win_prompt, v_win_prompt, conv_prompt = run_trunk(
        x_prompt, None, ln_g, ln_b, w_in, sinks, conv_w, w_branch_attn, w_branch_conv, w_out,
        ffn1_gu, ffn1_down, ffn2_gu, ffn2_down)
    y_sample, k_win_sample, v_win_sample, conv_sample = run_trunk(
        x_sample, (cache_k_win, cache_v_win, state_conv), ln_g, ln_b, w_in, sinks, conv_w,
        w_branch_attn, w_branch_conv, w_out, ffn1_gu, ffn1_down, ffn2_gu, ffn2_down)
    return (y_prompt, y_sample, k_win_prompt, v_win_prompt, conv_prompt,
            k_win_sample, v_win_sample, conv_sample)
```

```cpp
#include <hip/hip_runtime.h>
#include <cstdio>
#include <cstdint>

namespace nv {
constexpr int D = 2048, T = 2048, NB = 4, MP = NB * T, SB = 32, ST = 4, MS = SB * ST, M = MP + MS;
constexpr int DEPTH = 4, HD = 64, NH = 16, NKV = 4, GRP = 4, DQ = 1024, DKV = 256, DC = 1024, DFF = 5632, NIN = 8704, WIN = 128, PAST = 16384;
constexpr float ALPHA = 1.681792830507429f;
constexpr float LN_EPS = 1e-5f;

typedef short bf16x8 __attribute__((ext_vector_type(8)));
typedef float f32x4 __attribute__((ext_vector_type(4)));

__device__ __forceinline__ unsigned short f2bf(float f) { unsigned u = __float_as_uint(f); u += 0x7fffu + ((u >> 16) & 1u); return (unsigned short)(u >> 16); }
__device__ __forceinline__ float wave_sum(float v) {
#pragma unroll
    for (int o = 1; o < 64; o <<= 1) v += __shfl_xor(v, o);
    return v;
}

__global__ __launch_bounds__(256) void k_gemm(const float* __restrict__ A, int lda, const float* __restrict__ W, int ldw, float* __restrict__ C, int ldc, int K) {
    __shared__ __attribute__((aligned(16))) unsigned short As[128][40];
    __shared__ __attribute__((aligned(16))) unsigned short Bs[128][40];
    const int tid = threadIdx.x, lane = tid & 63, wave = tid >> 6, wm = wave >> 1, wn = wave & 1;
    const int row0 = blockIdx.y * 128, col0 = blockIdx.x * 128;
    f32x4 acc[4][4];
#pragma unroll
    for (int i = 0; i < 4; ++i)
#pragma unroll
        for (int j = 0; j < 4; ++j) acc[i][j] = (f32x4){0.f, 0.f, 0.f, 0.f};
    for (int k0 = 0; k0 < K; k0 += 32) {
#pragma unroll
        for (int i = 0; i < 4; ++i) {
            const int r = (tid >> 3) + 32 * i, kc = (tid & 7) * 4;
            const float4 v = *(const float4*)(A + (size_t)(row0 + r) * lda + k0 + kc);
            As[r][kc] = f2bf(v.x); As[r][kc + 1] = f2bf(v.y); As[r][kc + 2] = f2bf(v.z); As[r][kc + 3] = f2bf(v.w);
        }
#pragma unroll
        for (int i = 0; i < 4; ++i) {
            const int k = (tid >> 5) + 8 * i, n4 = (tid & 31) * 4;
            const float4 v = *(const float4*)(W + (size_t)(k0 + k) * ldw + col0 + n4);
            Bs[n4][k] = f2bf(v.x); Bs[n4 + 1][k] = f2bf(v.y); Bs[n4 + 2][k] = f2bf(v.z); Bs[n4 + 3][k] = f2bf(v.w);
        }
        __syncthreads();
        bf16x8 a[4], b[4];
#pragma unroll
        for (int i = 0; i < 4; ++i) a[i] = *(const bf16x8*)&As[wm * 64 + i * 16 + (lane & 15)][(lane >> 4) * 8];
#pragma unroll
        for (int j = 0; j < 4; ++j) b[j] = *(const bf16x8*)&Bs[wn * 64 + j * 16 + (lane & 15)][(lane >> 4) * 8];
#pragma unroll
        for (int i = 0; i < 4; ++i)
#pragma unroll
            for (int j = 0; j < 4; ++j) acc[i][j] = __builtin_amdgcn_mfma_f32_16x16x32_bf16(a[i], b[j], acc[i][j], 0, 0, 0);
        __syncthreads();
    }
#pragma unroll
    for (int i = 0; i < 4; ++i)
#pragma unroll
        for (int j = 0; j < 4; ++j)
#pragma unroll
            for (int e = 0; e < 4; ++e)
                C[(size_t)(row0 + wm * 64 + i * 16 + (lane >> 4) * 4 + e) * ldc + col0 + wn * 64 + j * 16 + (lane & 15)] = acc[i][j][e];
}

__global__ void k_copy_x(const float* __restrict__ xp, const float* __restrict__ xs, float* __restrict__ x) {
    const size_t i = (size_t)blockIdx.x * blockDim.x + threadIdx.x;
    if (i < (size_t)MP * D) x[i] = xp[i]; else if (i < (size_t)M * D) x[i] = xs[i - (size_t)MP * D];
}
__global__ void k_swiglu(const float* __restrict__ h, float* __restrict__ act) {
    const size_t i = (size_t)blockIdx.x * blockDim.x + threadIdx.x;
    if (i >= (size_t)M * DFF) return;
    const size_t m = i / DFF, c = i % DFF;
    const float g = h[m * (2 * DFF) + c], u = h[m * (2 * DFF) + DFF + c];
    act[i] = g / (1.f + expf(-g)) * u;
}
__global__ __launch_bounds__(256) void k_ln(float* __restrict__ x, const float* __restrict__ f, float scale, const float* __restrict__ g, const float* __restrict__ b) {
    const int row = blockIdx.x * 4 + (threadIdx.x >> 6), lane = threadIdx.x & 63;
    if (row >= M) return;
    float v[32]; float s = 0.f;
#pragma unroll
    for (int j = 0; j < 32; ++j) { const int c = lane + 64 * j; v[j] = ALPHA * x[(size_t)row * D + c] + scale * f[(size_t)row * D + c]; s += v[j]; }
    const float mu = wave_sum(s) * (1.f / D); float q = 0.f;
#pragma unroll
    for (int j = 0; j < 32; ++j) { v[j] -= mu; q += v[j] * v[j]; }
    const float rstd = 1.f / sqrtf(wave_sum(q) * (1.f / D) + LN_EPS);
#pragma unroll
    for (int j = 0; j < 32; ++j) { const int c = lane + 64 * j; x[(size_t)row * D + c] = v[j] * rstd * g[c] + b[c]; }
}
__device__ __forceinline__ int row_pos(int m) { return m < MP ? (m % T) : PAST + ((m - MP) % ST); }
__global__ void k_post_in(float* __restrict__ p, int l, float* __restrict__ out_kp, float* __restrict__ out_vp, float* __restrict__ out_cp,
                          float* __restrict__ out_ks, float* __restrict__ out_vs, float* __restrict__ out_cs, const float* __restrict__ cache_k, const float* __restrict__ cache_v) {
    const int m = blockIdx.x; float* pr = p + (size_t)m * NIN; const int pos = row_pos(m);
    for (int i = threadIdx.x; i < 20 * 32; i += blockDim.x) {
        const int hh = i / 32, d = i % 32;
        const float inv = powf(10000.f, -(float)(2 * d) / 64.f); const float ang = (float)pos * inv;
        const float c = cosf(ang), s = sinf(ang);
        const float x1 = pr[hh * 64 + d], x2 = pr[hh * 64 + 32 + d];
        pr[hh * 64 + d] = x1 * c - x2 * s; pr[hh * 64 + 32 + d] = x2 * c + x1 * s;
    }
    for (int c = threadIdx.x; c < DC; c += blockDim.x) pr[2560 + c] = pr[2560 + c] * pr[3584 + c];
    __syncthreads();
    if (m < MP) {
        const int b = m / T, t = m % T;
        if (t >= T - WIN) { const int j = t - (T - WIN);
            for (int c = threadIdx.x; c < DKV; c += blockDim.x) { out_kp[(((size_t)l * NB + b) * WIN + j) * DKV + c] = pr[DQ + c]; out_vp[(((size_t)l * NB + b) * WIN + j) * DKV + c] = pr[DQ + DKV + c]; } }
        if (t >= T - 2) { const int j = t - (T - 2);
            for (int c = threadIdx.x; c < DC; c += blockDim.x) out_cp[(((size_t)l * NB + b) * 2 + j) * DC + c] = pr[2560 + c]; }
    } else {
        const int b = (m - MP) / ST, s = (m - MP) % ST;
        { const int j = WIN - ST + s;
          for (int c = threadIdx.x; c < DKV; c += blockDim.x) { out_ks[(((size_t)l * SB + b) * WIN + j) * DKV + c] = pr[DQ + c]; out_vs[(((size_t)l * SB + b) * WIN + j) * DKV + c] = pr[DQ + DKV + c]; } }
        if (s >= ST - 2) { const int j = s - (ST - 2);
            for (int c = threadIdx.x; c < DC; c += blockDim.x) out_cs[(((size_t)l * SB + b) * 2 + j) * DC + c] = pr[2560 + c]; }
        if (s == 0) {
            for (int i = threadIdx.x; i < (WIN - ST) * DKV; i += blockDim.x) {
                const size_t src = (((size_t)l * SB + b) * WIN + ST) * DKV + i, dst = (((size_t)l * SB + b) * WIN) * DKV + i;
                out_ks[dst] = cache_k[src]; out_vs[dst] = cache_v[src]; }
        }
    }
}
__global__ __launch_bounds__(256) void k_attn(const float* __restrict__ p, int l, const float* __restrict__ cache_k, const float* __restrict__ cache_v, const float* __restrict__ sinks, float* __restrict__ attn) {
    const int m = blockIdx.x >> 2, kv = blockIdx.x & 3, g = threadIdx.x >> 6, lane = threadIdx.x & 63, h = kv * GRP + g;
    const float qd = p[(size_t)m * NIN + h * 64 + lane] * 0.125f;
    float mrun = sinks[l * NH + h], lrun = 1.f, acc = 0.f;
    if (m < MP) {
        const int b = m / T, t = m % T; const int t0 = t - WIN < 0 ? 0 : t - WIN;
        for (int tk = t0; tk <= t; ++tk) {
            const float* kr = p + (size_t)(b * T + tk) * NIN;
            const float s = wave_sum(qd * kr[DQ + kv * 64 + lane]); const float vv = kr[DQ + DKV + kv * 64 + lane];
            const float mn = fmaxf(mrun, s), sc = expf(mrun - mn), pe = expf(s - mn);
            lrun = lrun * sc + pe; acc = acc * sc + pe * vv; mrun = mn;
        }
    } else {
        const int b = (m - MP) / ST, s0 = (m - MP) % ST;
        for (int j = s0; j <= s0 + WIN; ++j) {
            float kk, vv;
            if (j < WIN) { const size_t o = ((((size_t)l * SB + b) * WIN + j) * NKV + kv) * HD + lane; kk = cache_k[o]; vv = cache_v[o]; }
            else { const float* kr = p + (size_t)(MP + b * ST + (j - WIN)) * NIN; kk = kr[DQ + kv * 64 + lane]; vv = kr[DQ + DKV + kv * 64 + lane]; }
            const float s = wave_sum(qd * kk);
            const float mn = fmaxf(mrun, s), sc = expf(mrun - mn), pe = expf(s - mn);
            lrun = lrun * sc + pe; acc = acc * sc + pe * vv; mrun = mn;
        }
    }
    attn[(size_t)m * DQ + h * 64 + lane] = acc / lrun;
}
__global__ void k_conv(const float* __restrict__ p, int l, const float* __restrict__ state, const float* __restrict__ cw, float* __restrict__ yconv) {
    const int m = blockIdx.x;
    for (int c = threadIdx.x; c < DC; c += blockDim.x) {
        float um1, um2; const float u0 = p[(size_t)m * NIN + 2560 + c];
        if (m < MP) { const int t = m % T; um1 = t >= 1 ? p[(size_t)(m - 1) * NIN + 2560 + c] : 0.f; um2 = t >= 2 ? p[(size_t)(m - 2) * NIN + 2560 + c] : 0.f; }
        else { const int b = (m - MP) / ST, s = (m - MP) % ST; const float* st = state + ((size_t)l * SB + b) * 2 * DC;
            um1 = s >= 1 ? p[(size_t)(m - 1) * NIN + 2560 + c] : st[DC + c];
            um2 = s >= 2 ? p[(size_t)(m - 2) * NIN + 2560 + c] : st[(s + 0) * DC + c]; }
        const float cv = cw[(l * 3 + 0) * DC + c] * um2 + cw[(l * 3 + 1) * DC + c] * um1 + cw[(l * 3 + 2) * DC + c] * u0;
        yconv[(size_t)m * DC + c] = p[(size_t)m * NIN + 1536 + c] * cv;
    }
}
__global__ void k_merge(const float* __restrict__ p, const float* __restrict__ ba, const float* __restrict__ bc, float* __restrict__ merged) {
    const size_t i = (size_t)blockIdx.x * blockDim.x + threadIdx.x;
    if (i >= (size_t)M * D) return;
    const size_t m = i / D, c = i % D;
    const float ga = p[m * NIN + 4608 + c], gc = p[m * NIN + 6656 + c];
    merged[i] = ba[i] / (1.f + expf(-ga)) + bc[i] / (1.f + expf(-gc));
}
__global__ void k_out(const float* __restrict__ x, float* __restrict__ yp, float* __restrict__ ys) {
    const size_t i = (size_t)blockIdx.x * blockDim.x + threadIdx.x;
    if (i < (size_t)MP * D) yp[i] = x[i]; else if (i < (size_t)M * D) ys[i - (size_t)MP * D] = x[i];
}
}

extern "C" void kernel_launch(void* const* d_in, const int* in_sizes, int n_in, void* d_out, int out_size, void* d_ws, size_t ws_size, hipStream_t stream) {
    using namespace nv;
    const float* x_prompt = (const float*)d_in[0]; const float* x_sample = (const float*)d_in[1];
    const float* cache_k = (const float*)d_in[2]; const float* cache_v = (const float*)d_in[3]; const float* state_conv = (const float*)d_in[4];
    const float* ln_g = (const float*)d_in[5]; const float* ln_b = (const float*)d_in[6]; const float* w_in = (const float*)d_in[7];
    const float* sinks = (const float*)d_in[8]; const float* conv_w = (const float*)d_in[9]; const float* wba = (const float*)d_in[10];
    const float* wbc = (const float*)d_in[11]; const float* w_out = (const float*)d_in[12]; const float* f1gu = (const float*)d_in[13];
    const float* f1dn = (const float*)d_in[14]; const float* f2gu = (const float*)d_in[15]; const float* f2dn = (const float*)d_in[16];
    float* out = (float*)d_out;
    float* o_yp = out; float* o_ys = o_yp + (size_t)MP * D; float* o_kp = o_ys + (size_t)MS * D; float* o_vp = o_kp + (size_t)DEPTH * NB * WIN * DKV;
    float* o_cp = o_vp + (size_t)DEPTH * NB * WIN * DKV; float* o_ks = o_cp + (size_t)DEPTH * NB * 2 * DC; float* o_vs = o_ks + (size_t)DEPTH * SB * WIN * DKV;
    float* o_cs = o_vs + (size_t)DEPTH * SB * WIN * DKV;
    float* ws = (float*)d_ws;
    float* x = ws; float* big = x + (size_t)M * D;
    float* act = big + (size_t)M * 2 * DFF;
    float* f = act + (size_t)M * DFF;
    float* attn = act; float* yconv = attn + (size_t)M * DQ; float* ba = yconv + (size_t)M * DC; float* bc = big + (size_t)M * NIN; float* merged = f;
    const size_t need = ((size_t)(f - ws) + (size_t)M * D) * 4;
    if (ws_size < need) { fprintf(stderr, "ws too small: %zu < %zu\n", ws_size, need); return; }
    const int nMD = (int)(((size_t)M * D + 255) / 256);
    k_copy_x<<<nMD, 256, 0, stream>>>(x_prompt, x_sample, x);
    for (int l = 0; l < DEPTH; ++l) {
        for (int half = 0; half < 2; ++half) {
            if (half == 1) {
                float* p = big;
                k_gemm<<<dim3(NIN / 128, M / 128), 256, 0, stream>>>(x, D, w_in + (size_t)l * D * NIN, NIN, p, NIN, D);
                k_post_in<<<M, 256, 0, stream>>>(p, l, o_kp, o_vp, o_cp, o_ks, o_vs, o_cs, cache_k, cache_v);
                k_attn<<<M * 4, 256, 0, stream>>>(p, l, cache_k, cache_v, sinks, attn);
                k_conv<<<M, 256, 0, stream>>>(p, l, state_conv, conv_w, yconv);
                k_gemm<<<dim3(D / 128, M / 128), 256, 0, stream>>>(attn, DQ, wba + (size_t)l * DQ * D, D, ba, D, DQ);
                k_gemm<<<dim3(D / 128, M / 128), 256, 0, stream>>>(yconv, DC, wbc + (size_t)l * DC * D, D, bc, D, DC);
                k_merge<<<nMD, 256, 0, stream>>>(p, ba, bc, merged);
                k_gemm<<<dim3(D / 128, M / 128), 256, 0, stream>>>(merged, D, w_out + (size_t)l * D * D, D, ba, D, D);
                k_ln<<<(M + 3) / 4, 256, 0, stream>>>(x, ba, 1.0f, ln_g + (size_t)(l * 3 + 1) * D, ln_b + (size_t)(l * 3 + 1) * D);
            }
            const float* gu = (half == 0 ? f1gu : f2gu) + (size_t)l * D * 2 * DFF; const float* dn = (half == 0 ? f1dn : f2dn) + (size_t)l * DFF * D;
            const int lni = half == 0 ? 0 : 2;
            k_gemm<<<dim3(2 * DFF / 128, M / 128), 256, 0, stream>>>(x, D, gu, 2 * DFF, big, 2 * DFF, D);
            k_swiglu<<<(int)(((size_t)M * DFF + 255) / 256), 256, 0, stream>>>(big, act);
            k_gemm<<<dim3(D / 128, M / 128), 256, 0, stream>>>(act, DFF, dn, D, f, D, DFF);
            k_ln<<<(M + 3) / 4, 256, 0, stream>>>(x, f, 0.5f, ln_g + (size_t)(l * 3 + lni) * D, ln_b + (size_t)(l * 3 + lni) * D);
        }
    }
    k_out<<<nMD, 256, 0, stream>>>(x, o_yp, o_ys);
}
```

```cpp
#include <hip/hip_runtime.h>
#include <cstdio>
#include <cstdint>

#define LAS __attribute__((address_space(3)))
typedef unsigned short bf16_t;
typedef short bf16x8 __attribute__((ext_vector_type(8)));
typedef short s16x4 __attribute__((ext_vector_type(4)));
typedef float f32x4 __attribute__((ext_vector_type(4)));
typedef float f32x2 __attribute__((ext_vector_type(2)));
typedef float f32x16 __attribute__((ext_vector_type(16)));
typedef unsigned u32x4 __attribute__((ext_vector_type(4)));
typedef unsigned u32x2 __attribute__((ext_vector_type(2)));
typedef __bf16 bf16x2_t __attribute__((ext_vector_type(2)));

constexpr int D = 2048, T = 2048, NB = 4, MP = NB * T, SB = 32, ST = 4, MS = SB * ST, M = MP + MS, MPAD = 8448;
constexpr int DEPTH = 4, NH = 16, NKV = 4, DQ = 1024, DKV = 256, DC = 1024, DFF = 5632, NGU = 2 * DFF, NIN = 8704, WIN = 128, PAST = 16384;
constexpr float ALPHA = 1.681792830507429f, LN_EPS = 1e-5f;
constexpr int NCV = NGU + NIN + NGU;
constexpr int CV_GU1 = 0, CV_IN = NGU, CV_GU2 = NGU + NIN;

constexpr size_t MiB = 1u << 20;
constexpr size_t WS_CTL = 0, CTL_ZERO_BYTES = 64 * 1024;
constexpr size_t WS_ROPE = 1 * MiB;
constexpr size_t WS_C1 = 2 * MiB, WS_C2 = 3 * MiB;
constexpr size_t WS_PART = 4 * MiB;
constexpr size_t WS_SLOT0 = 36 * MiB, WS_SLOT1 = 39 * MiB;
constexpr size_t WS_Y = 42 * MiB;
constexpr size_t WS_YB = 108 * MiB;
constexpr size_t WS_ACT = 141 * MiB;
constexpr size_t WS_Q = 232 * MiB;
constexpr size_t WS_K = 249 * MiB, WS_V = 254 * MiB;
constexpr size_t WS_CB = 259 * MiB, WS_U = 276 * MiB;
constexpr size_t WS_SA = 293 * MiB, WS_SC = 326 * MiB;
constexpr size_t WS_AO = 359 * MiB;
constexpr size_t WS_MG = 392 * MiB;
constexpr size_t WS_W = 426 * MiB;
constexpr size_t WL_GU1 = 0, WL_DN1 = 44 * MiB, WL_IN = 66 * MiB, WL_BR = 100 * MiB, WL_OUT = 108 * MiB, WL_GU2 = 116 * MiB, WL_DN2 = 160 * MiB, WL_BYTES = 182 * MiB;
constexpr size_t WS_END = WS_W + DEPTH * WL_BYTES;
constexpr int CW_BAR = 1024;
constexpr size_t O_YP = 0, O_YS = O_YP + (size_t)MP * D, O_KP = O_YS + (size_t)MS * D, O_VP = O_KP + (size_t)DEPTH * NB * WIN * DKV, O_CP = O_VP + (size_t)DEPTH * NB * WIN * DKV,
                 O_KS = O_CP + (size_t)DEPTH * NB * 2 * DC, O_VS = O_KS + (size_t)DEPTH * SB * WIN * DKV, O_CS = O_VS + (size_t)DEPTH * SB * WIN * DKV, O_END = O_CS + (size_t)DEPTH * SB * 2 * DC;

namespace pg8 {
constexpr int BM = 256, BK = 64, HALF = 128, HTB = HALF * BK * 2, STAGE_BYTES = 8 * HTB, NXCD = 8, WGM = 8;
__host__ __device__ __forceinline__ int lds_byte(int r, int c) { const int st = (r >> 4) * 2 + (c >> 5), rr = r & 15, cc = c & 31, ob = rr * 64 + cc * 2; return st * 1024 + (ob ^ (((ob >> 9) & 1) << 5)); }
__host__ __device__ __forceinline__ void stage_rc(int b, int& R, int& C) { const int st = b / 1024, sb = b % 1024, swz = sb ^ (((sb >> 9) & 1) << 5); R = (st >> 1) * 16 + swz / 64; C = (st & 1) * 32 + (swz % 64) / 2; }
__host__ __device__ __forceinline__ int perm32(int rho) { const int n = rho >> 4, i = rho & 15; return 8 * (i >> 2) + 4 * n + (i & 3); }
struct Unit { int pm, pn; };
struct Gemm { const bf16_t* A; const bf16_t* Bt; int M, N, K; };
struct StaticOrder {
    int nM, nN, nwg, G, c;
    __device__ void init(int M_, int N_, int G_, int c_) { nM = M_ / BM; nN = N_ / BM; nwg = nM * nN; G = G_; c = c_; }
    __device__ bool next(int i, Unit& u) const {
        const long L = (long)i * G + c; if (L >= nwg) return false;
        int wgid = (int)L; { const int q = nwg / NXCD, r = nwg % NXCD, xcd = wgid % NXCD, off = wgid / NXCD; wgid = (xcd < r ? xcd * (q + 1) : r * (q + 1) + (xcd - r) * q) + off; }
        const int nig = WGM * nN, gid = wgid / nig, fm = gid * WGM, gsz = (nM - fm) < WGM ? (nM - fm) : WGM;
        u.pm = fm + ((wgid % nig) % gsz); u.pn = (wgid % nig) / gsz; return true;
    }
};
template <class Epi, class Sched>
__device__ __forceinline__ void gemm_phase(LAS unsigned char* lds, const Gemm g, const Sched& S, const Epi& E) {
    int tid_l = threadIdx.x; asm volatile("" : "+v"(tid_l));
    const int tid = tid_l, wid = __builtin_amdgcn_readfirstlane(tid >> 6), lane = tid & 63, wr = wid >> 2, wc = wid & 3, fr = lane & 15, fq = lane >> 4;
    const int K = g.K, nt = K / BK;
    unsigned voffA[2], voffB[2];
#pragma unroll
    for (int i = 0; i < 2; ++i) { int R, C; stage_rc(tid * 16 + i * 8192, R, C); const int Rb = (R & ~31) + perm32(R & 31);
        voffA[i] = (unsigned)(R * K + C) * 2u; voffB[i] = (unsigned)(Rb * K + C) * 2u; }
    const size_t kstep = (size_t)(BK * 2), hstep = (size_t)HALF * K * 2, tstep = 2 * hstep;
    const unsigned ldsw = (unsigned)wid * 1024u;
    const int aoff = lds_byte(wr * 64 + fr, fq * 8), boff = lds_byte(wc * 32 + fr, fq * 8);
    LAS float* const tab0 = (LAS float*)(lds + STAGE_BYTES);
#define PG8_SA(b, h) (((b) * 2 + (h)) * HTB)
#define PG8_SB(b, h) ((4 + (b) * 2 + (h)) * HTB)
#define PG8_STAGE(bufoff, gbase, voff) do { _Pragma("unroll") for (int _i = 0; _i < 2; ++_i) \
        __builtin_amdgcn_global_load_lds((const unsigned*)((const char*)(gbase) + (voff)[_i]), (LAS unsigned*)(lds + (bufoff) + ldsw + _i * 8192), 16, 0, 0); } while (0)
#define PG8_LDA(dst, b, h) do { _Pragma("unroll") for (int m = 0; m < 4; ++m) _Pragma("unroll") for (int k = 0; k < 2; ++k) dst[m][k] = *(const LAS bf16x8*)(lds + PG8_SA(b, h) + aoff + m * 2048 + k * 1024); } while (0)
#define PG8_LDB(dst, b, h) do { _Pragma("unroll") for (int n = 0; n < 2; ++n) _Pragma("unroll") for (int k = 0; k < 2; ++k) dst[n][k] = *(const LAS bf16x8*)(lds + PG8_SB(b, h) + boff + n * 2048 + k * 1024); } while (0)
#define PG8_MMA(ai, bj, At, Bt) do { __builtin_amdgcn_s_setprio(1); _Pragma("unroll") for (int m = 0; m < 4; ++m) _Pragma("unroll") for (int n = 0; n < 2; ++n) _Pragma("unroll") for (int k = 0; k < 2; ++k) \
        acc[ai][bj][m][n] = __builtin_amdgcn_mfma_f32_16x16x32_bf16(Bt[n][k], At[m][k], acc[ai][bj][m][n], 0, 0, 0); __builtin_amdgcn_s_setprio(0); } while (0)
#define PG8_WAIT_V(n) asm volatile("s_waitcnt vmcnt(" #n ")" ::: "memory")
#define PG8_WAIT_L(n) asm volatile("s_waitcnt lgkmcnt(" #n ")" ::: "memory")
#define PG8_BAR __builtin_amdgcn_s_barrier()
#define PG8_SCHED __builtin_amdgcn_sched_barrier(0)
    Unit cur, nxt; int ui = 0;
    if (!S.next(0, cur)) return;
    f32x4 acc[2][2][4][2];
#pragma unroll
    for (int a = 0; a < 2; ++a)
#pragma unroll
        for (int b = 0; b < 2; ++b)
#pragma unroll
            for (int m = 0; m < 4; ++m)
#pragma unroll
                for (int n = 0; n < 2; ++n) acc[a][b][m][n] = (f32x4){0.f, 0.f, 0.f, 0.f};
    bf16x8 At[4][2], B0[2][2], B1[2][2];
    const char* cA = (const char*)g.A + (size_t)cur.pm * tstep; const char* cB = (const char*)g.Bt + (size_t)cur.pn * tstep;
    E.prep(tab0, cur, tid);
    PG8_STAGE(PG8_SB(0, 0), cB, voffB); PG8_STAGE(PG8_SB(0, 1), cB + hstep, voffB); PG8_STAGE(PG8_SA(0, 0), cA, voffA); PG8_STAGE(PG8_SA(0, 1), cA + hstep, voffA);
    if (wr == 1) PG8_BAR;
    PG8_WAIT_V(2); PG8_BAR;
    PG8_STAGE(PG8_SB(1, 0), cB + kstep, voffB); PG8_STAGE(PG8_SA(1, 0), cA + kstep, voffA); PG8_STAGE(PG8_SB(1, 1), cB + hstep + kstep, voffB);
    PG8_WAIT_V(6); PG8_BAR;
    for (;;) {
        const bool has_next = S.next(ui + 1, nxt);
        const char* nA = has_next ? (const char*)g.A + (size_t)nxt.pm * tstep : cA; const char* nB = has_next ? (const char*)g.Bt + (size_t)nxt.pn * tstep : cB;
        for (int t = 0; t < nt; t += 2) {
            const bool last = (t == nt - 2);
            const char* a1 = cA + (size_t)(t + 1) * kstep;
            const char* a2 = last ? nA : cA + (size_t)(t + 2) * kstep; const char* b2 = last ? nB : cB + (size_t)(t + 2) * kstep;
            const char* a3 = a2 + kstep; const char* b3 = b2 + kstep;
            if constexpr (Epi::HAS_MID) { if (t == (nt >> 1)) { int fr_e = fr, fq_e = fq; asm volatile("" : "+v"(fr_e), "+v"(fq_e)); E.mid(acc, cur, wr, wc, fr_e, fq_e); PG8_SCHED; } }
            PG8_LDB(B0, 0, 0); PG8_LDB(B1, 0, 1); PG8_SCHED; PG8_LDA(At, 0, 0); PG8_STAGE(PG8_SA(1, 1), a1 + hstep, voffA);
            PG8_WAIT_V(8); PG8_WAIT_L(0); PG8_BAR; PG8_MMA(0, 0, At, B0); PG8_MMA(0, 1, At, B1); PG8_BAR; PG8_SCHED;
            PG8_LDA(At, 0, 1); PG8_STAGE(PG8_SB(0, 0), b2, voffB); PG8_STAGE(PG8_SB(0, 1), b2 + hstep, voffB); PG8_STAGE(PG8_SA(0, 0), a2, voffA);
            PG8_WAIT_V(8); PG8_WAIT_L(0); PG8_BAR; PG8_MMA(1, 0, At, B0); PG8_MMA(1, 1, At, B1); PG8_BAR; PG8_SCHED;
            PG8_LDB(B0, 1, 0); PG8_LDB(B1, 1, 1); PG8_SCHED; PG8_LDA(At, 1, 0); PG8_STAGE(PG8_SA(0, 1), a2 + hstep, voffA);
            PG8_WAIT_V(8); PG8_WAIT_L(0); PG8_BAR; PG8_MMA(0, 0, At, B0); PG8_MMA(0, 1, At, B1); PG8_BAR; PG8_SCHED;
            PG8_LDA(At, 1, 1); PG8_STAGE(PG8_SB(1, 0), b3, voffB); PG8_STAGE(PG8_SB(1, 1), b3 + hstep, voffB); PG8_STAGE(PG8_SA(1, 0), a3, voffA);
            PG8_WAIT_V(8); PG8_WAIT_L(0); PG8_BAR; PG8_MMA(1, 0, At, B0); PG8_MMA(1, 1, At, B1); PG8_BAR; PG8_SCHED;
        }
        if (wr == 0) PG8_BAR;
        { int fr_e = fr, fq_e = fq; asm volatile("" : "+v"(fr_e), "+v"(fq_e));
          E(acc, cur, wr, wc, fr_e, fq_e, tab0 + (ui & 1) * 512); }
        if (!has_next) break;
        E.prep(tab0 + ((ui + 1) & 1) * 512, nxt, tid);
#pragma unroll
        for (int a = 0; a < 2; ++a)
#pragma unroll
            for (int b = 0; b < 2; ++b)
#pragma unroll
                for (int m = 0; m < 4; ++m)
#pragma unroll
                    for (int n = 0; n < 2; ++n) acc[a][b][m][n] = (f32x4){0.f, 0.f, 0.f, 0.f};
        cur = nxt; cA = nA; cB = nB; ++ui;
        if (wr == 1) PG8_BAR;
    }
    PG8_WAIT_V(0);
    PG8_BAR;
#undef PG8_SA
#undef PG8_SB
#undef PG8_STAGE
#undef PG8_LDA
#undef PG8_LDB
#undef PG8_MMA
#undef PG8_WAIT_V
#undef PG8_WAIT_L
#undef PG8_BAR
#undef PG8_SCHED
}
}
using pg8::Unit;

__device__ __forceinline__ unsigned pk2(float lo, float hi) { f32x2 v = {lo, hi}; bf16x2_t b = __builtin_convertvector(v, bf16x2_t); return __builtin_bit_cast(unsigned, b); }
__device__ __forceinline__ u32x4 pk8(f32x4 a, f32x4 b) { u32x4 w; w.x = pk2(a[0], a[1]); w.y = pk2(a[2], a[3]); w.z = pk2(b[0], b[1]); w.w = pk2(b[2], b[3]); return w; }
__device__ __forceinline__ float bflo(unsigned w) { return __uint_as_float(w << 16); }
__device__ __forceinline__ float bfhi(unsigned w) { return __uint_as_float(w & 0xffff0000u); }
__device__ __forceinline__ void unpk8(u32x4 w, f32x4& a, f32x4& b) { a = (f32x4){bflo(w.x), bfhi(w.x), bflo(w.y), bfhi(w.y)}; b = (f32x4){bflo(w.z), bfhi(w.z), bflo(w.w), bfhi(w.w)}; }
__device__ __forceinline__ float sigmoidf_fast(float x) { return __builtin_amdgcn_rcpf(1.f + __expf(-x)); }
__device__ __forceinline__ f32x4 sig4(f32x4 v) { return (f32x4){sigmoidf_fast(v[0]), sigmoidf_fast(v[1]), sigmoidf_fast(v[2]), sigmoidf_fast(v[3])}; }

__device__ __forceinline__ void finalize_stats(const float* slots, int pm, int ident, LAS float* tab, int tid) {
    const int row = tid >> 1, half = tid & 1; float s = 0.f, q = 0.f;
    if (!ident) { const f32x4* p = (const f32x4*)(slots + ((size_t)(pm * 256 + row) * 32 + half * 16) * 2);
#pragma unroll
        for (int i = 0; i < 8; ++i) { const f32x4 v = p[i]; s += v[0] + v[2]; q += v[1] + v[3]; } }
    s += __shfl_xor(s, 1); q += __shfl_xor(q, 1);
    const float mu = s * (1.f / D); float var = q * (1.f / D) - mu * mu; var = var < 0.f ? 0.f : var;
    float rstd = 1.f / sqrtf(var + LN_EPS), rm = rstd * mu;
    if (ident) { rstd = 1.f; rm = 0.f; }
    if (half == 0) { tab[row * 2] = rstd; tab[row * 2 + 1] = rm; }
}

struct EpiGU {
    static constexpr bool HAS_MID = false;
    unsigned char* ws; int cvoff; int lnpar; int ident;
    __device__ __forceinline__ void prep(LAS float* tab, const Unit& u, int tid) const { finalize_stats((const float*)(ws + (lnpar ? WS_SLOT1 : WS_SLOT0)), u.pm, ident, tab, tid); }
    __device__ __forceinline__ void operator()(const f32x4 (&acc)[2][2][4][2], const Unit& u, int wr, int wc, int fr, int fq, const LAS float* tab) const {
        const int col0 = u.pn * 256 + wc * 32 + 8 * fq;
        const float* c1 = (const float*)(ws + WS_C1) + cvoff; const float* c2 = (const float*)(ws + WS_C2) + cvoff; bf16_t* act = (bf16_t*)(ws + WS_ACT);
        f32x4 k1[2][2], k2[2][2];
#pragma unroll
        for (int bj = 0; bj < 2; ++bj)
#pragma unroll
            for (int n = 0; n < 2; ++n) {
                if (ident) { k1[bj][n] = (f32x4){0.f, 0.f, 0.f, 0.f}; k2[bj][n] = (f32x4){0.f, 0.f, 0.f, 0.f}; }
                else { k1[bj][n] = *(const f32x4*)(c1 + col0 + bj * 128 + 4 * n); k2[bj][n] = *(const f32x4*)(c2 + col0 + bj * 128 + 4 * n); } }
#pragma unroll
        for (int ai = 0; ai < 2; ++ai)
#pragma unroll
            for (int m = 0; m < 4; ++m) {
                const int r = ai * 128 + wr * 64 + m * 16 + fr; const float rs = tab[r * 2], rm = tab[r * 2 + 1];
                f32x4 o[2];
#pragma unroll
                for (int n = 0; n < 2; ++n) {
                    const f32x4 gv = acc[ai][0][m][n] * rs + (k2[0][n] - k1[0][n] * rm), uv = acc[ai][1][m][n] * rs + (k2[1][n] - k1[1][n] * rm);
                    o[n] = gv * sig4(gv) * uv; }
                *(u32x4*)(act + (size_t)(u.pm * 256 + r) * DFF + u.pn * 128 + wc * 32 + 8 * fq) = pk8(o[0], o[1]);
            }
    }
};

struct EpiRes {
    static constexpr bool HAS_MID = false;
    unsigned char* ws; const float* g; const float* b; float scale; int lnpar; int ident;
    __device__ __forceinline__ void prep(LAS float* tab, const Unit& u, int tid) const { finalize_stats((const float*)(ws + (lnpar ? WS_SLOT1 : WS_SLOT0)), u.pm, ident, tab, tid); }
    __device__ __forceinline__ void operator()(const f32x4 (&acc)[2][2][4][2], const Unit& u, int wr, int wc, int fr, int fq, const LAS float* tab) const {
        const int col0 = u.pn * 256 + wc * 32 + 8 * fq;
        float* y = (float*)(ws + WS_Y); bf16_t* yb = (bf16_t*)(ws + WS_YB); float* slots_out = (float*)(ws + (lnpar ? WS_SLOT0 : WS_SLOT1));
        f32x4 gv[2][2], bv[2][2];
#pragma unroll
        for (int bj = 0; bj < 2; ++bj)
#pragma unroll
            for (int n = 0; n < 2; ++n) {
                if (ident) { gv[bj][n] = (f32x4){1.f, 1.f, 1.f, 1.f}; bv[bj][n] = (f32x4){0.f, 0.f, 0.f, 0.f}; }
                else { gv[bj][n] = *(const f32x4*)(g + col0 + bj * 128 + 4 * n); bv[bj][n] = *(const f32x4*)(b + col0 + bj * 128 + 4 * n); } }
#pragma unroll
        for (int ai = 0; ai < 2; ++ai)
#pragma unroll
            for (int m = 0; m < 4; ++m) {
                const int r = ai * 128 + wr * 64 + m * 16 + fr; const float rs = tab[r * 2], rm = tab[r * 2 + 1];
                const size_t off = (size_t)(u.pm * 256 + r) * D + col0; float s = 0.f, q = 0.f;
#pragma unroll
                for (int bj = 0; bj < 2; ++bj) { f32x4 o[2];
#pragma unroll
                    for (int n = 0; n < 2; ++n) { const f32x4 yo = *(const f32x4*)(y + off + bj * 128 + 4 * n);
                        const f32x4 x = (yo * rs - rm) * gv[bj][n] + bv[bj][n]; o[n] = x * ALPHA + acc[ai][bj][m][n] * scale;
                        *(f32x4*)(y + off + bj * 128 + 4 * n) = o[n];
                        s += (o[n][0] + o[n][1]) + (o[n][2] + o[n][3]); q += (o[n][0] * o[n][0] + o[n][1] * o[n][1]) + (o[n][2] * o[n][2] + o[n][3] * o[n][3]); }
                    *(u32x4*)(yb + off + bj * 128) = pk8(o[0], o[1]); }
                s += __shfl_xor(s, 16); q += __shfl_xor(q, 16); s += __shfl_xor(s, 32); q += __shfl_xor(q, 32);
                if (fq == 0) *(f32x2*)(slots_out + ((size_t)(u.pm * 256 + r) * 32 + u.pn * 4 + wc) * 2) = (f32x2){s, q};
                asm volatile("" ::: "memory");
            }
    }
};

struct EpiIn {
    static constexpr bool HAS_MID = false;
    unsigned char* ws; float* out; int l; int lnpar;
    __device__ __forceinline__ void prep(LAS float* tab, const Unit& u, int tid) const { finalize_stats((const float*)(ws + (lnpar ? WS_SLOT1 : WS_SLOT0)), u.pm, 0, tab, tid); }
    __device__ __forceinline__ void operator()(const f32x4 (&acc)[2][2][4][2], const Unit& u, int wr, int wc, int fr, int fq, const LAS float* tab) const {
        const float* c1 = (const float*)(ws + WS_C1) + (size_t)l * NCV + CV_IN; const float* c2 = (const float*)(ws + WS_C2) + (size_t)l * NCV + CV_IN; const float* rope = (const float*)(ws + WS_ROPE);
        bf16_t *Qb = (bf16_t*)(ws + WS_Q), *Kb = (bf16_t*)(ws + WS_K), *Vb = (bf16_t*)(ws + WS_V), *CB = (bf16_t*)(ws + WS_CB), *U = (bf16_t*)(ws + WS_U), *SA = (bf16_t*)(ws + WS_SA), *SC = (bf16_t*)(ws + WS_SC);
        float* okp = out + O_KP + (size_t)l * NB * WIN * DKV; float* ovp = out + O_VP + (size_t)l * NB * WIN * DKV; float* ocp = out + O_CP + (size_t)l * NB * 2 * DC;
        float* oks = out + O_KS + (size_t)l * SB * WIN * DKV; float* ovs = out + O_VS + (size_t)l * SB * WIN * DKV; float* ocs = out + O_CS + (size_t)l * SB * 2 * DC;
        const int col0 = u.pn * 256 + wc * 32 + 8 * fq, pn = u.pn;
        f32x4 k1[2][2], k2[2][2];
#pragma unroll
        for (int bj = 0; bj < 2; ++bj)
#pragma unroll
            for (int n = 0; n < 2; ++n) { k1[bj][n] = *(const f32x4*)(c1 + col0 + bj * 128 + 4 * n); k2[bj][n] = *(const f32x4*)(c2 + col0 + bj * 128 + 4 * n); }
#pragma unroll
        for (int ai = 0; ai < 2; ++ai)
#pragma unroll
            for (int m = 0; m < 4; ++m) {
                const int r = ai * 128 + wr * 64 + m * 16 + fr, grow = u.pm * 256 + r; const float rs = tab[r * 2], rm = tab[r * 2 + 1];
                f32x4 v[2][2];
#pragma unroll
                for (int bj = 0; bj < 2; ++bj)
#pragma unroll
                    for (int n = 0; n < 2; ++n) v[bj][n] = acc[ai][bj][m][n] * rs + (k2[bj][n] - k1[bj][n] * rm);
                int pidx = 0; float* kw = nullptr; float* vw = nullptr; float* cw = nullptr;
                if (grow < MP) { const int b = grow >> 11, t = grow & (T - 1); pidx = t;
                    if (t >= T - WIN) { kw = okp + ((size_t)b * WIN + (t - (T - WIN))) * DKV; vw = ovp + ((size_t)b * WIN + (t - (T - WIN))) * DKV; }
                    if (t >= T - 2) cw = ocp + ((size_t)b * 2 + (t - (T - 2))) * DC; }
                else if (grow < M) { const int i = grow - MP, b = i >> 2, s = i & 3; pidx = T + s;
                    kw = oks + ((size_t)b * WIN + (WIN - ST) + s) * DKV; vw = ovs + ((size_t)b * WIN + (WIN - ST) + s) * DKV;
                    if (s >= ST - 2) cw = ocs + ((size_t)b * 2 + (s - (ST - 2))) * DC; }
                if (pn <= 4) {
                    const float* rp = rope + (size_t)pidx * 64 + 8 * fq; f32x4 o1[2], o2[2];
#pragma unroll
                    for (int n = 0; n < 2; ++n) { const f32x4 cs = *(const f32x4*)(rp + 4 * n), sn = *(const f32x4*)(rp + 32 + 4 * n);
                        o1[n] = v[0][n] * cs - v[1][n] * sn; o2[n] = v[1][n] * cs + v[0][n] * sn; }
                    if (pn < 4) { bf16_t* qp = Qb + (size_t)grow * DQ + (pn * 4 + wc) * 64 + 8 * fq;
                        *(u32x4*)qp = pk8(o1[0] * 0.125f, o1[1] * 0.125f); *(u32x4*)(qp + 32) = pk8(o2[0] * 0.125f, o2[1] * 0.125f); }
                    else { bf16_t* kp = Kb + (size_t)grow * DKV + wc * 64 + 8 * fq; *(u32x4*)kp = pk8(o1[0], o1[1]); *(u32x4*)(kp + 32) = pk8(o2[0], o2[1]);
                        if (kw) { float* w = kw + wc * 64 + 8 * fq; *(f32x4*)w = o1[0]; *(f32x4*)(w + 4) = o1[1]; *(f32x4*)(w + 32) = o2[0]; *(f32x4*)(w + 36) = o2[1]; } }
                } else if (pn == 5) {
#pragma unroll
                    for (int bj = 0; bj < 2; ++bj) { *(u32x4*)(Vb + (size_t)grow * DKV + bj * 128 + wc * 32 + 8 * fq) = pk8(v[bj][0], v[bj][1]);
                        if (vw) { float* w = vw + bj * 128 + wc * 32 + 8 * fq; *(f32x4*)w = v[bj][0]; *(f32x4*)(w + 4) = v[bj][1]; } }
                } else if (pn < 10) {
#pragma unroll
                    for (int bj = 0; bj < 2; ++bj) *(u32x4*)(CB + (size_t)grow * DC + (pn - 6) * 256 + bj * 128 + wc * 32 + 8 * fq) = pk8(v[bj][0], v[bj][1]);
                } else if (pn < 18) {
                    const f32x4 u0 = v[0][0] * v[1][0], u1 = v[0][1] * v[1][1]; const int cc = (pn - 10) * 128 + wc * 32 + 8 * fq;
                    *(u32x4*)(U + (size_t)grow * DC + cc) = pk8(u0, u1);
                    if (cw) { *(f32x4*)(cw + cc) = u0; *(f32x4*)(cw + cc + 4) = u1; }
                } else { bf16_t* dst = (pn < 26 ? SA + (pn - 18) * 256 : SC + (pn - 26) * 256) + (size_t)grow * D + wc * 32 + 8 * fq;
#pragma unroll
                    for (int bj = 0; bj < 2; ++bj) *(u32x4*)(dst + bj * 128) = pk8(sig4(v[bj][0]), sig4(v[bj][1]));
                }
                asm volatile("" ::: "memory");
            }
    }
};

struct EpiBr {
    static constexpr bool HAS_MID = true;
    unsigned char* ws;
    __device__ __forceinline__ void prep(LAS float*, const Unit&, int) const {}
    __device__ __forceinline__ void mid(f32x4 (&acc)[2][2][4][2], const Unit& u, int wr, int wc, int fr, int fq) const {
        const bf16_t* SA = (const bf16_t*)(ws + WS_SA); const bf16_t* SC = (const bf16_t*)(ws + WS_SC);
#pragma unroll
        for (int ai = 0; ai < 2; ++ai)
#pragma unroll
            for (int m = 0; m < 4; ++m) { const size_t off = (size_t)(u.pm * 256 + ai * 128 + wr * 64 + m * 16 + fr) * D + u.pn * 256 + wc * 32 + 8 * fq;
#pragma unroll
                for (int bj = 0; bj < 2; ++bj) { f32x4 a0, a1, c0, c1; unpk8(*(const u32x4*)(SA + off + bj * 128), a0, a1); unpk8(*(const u32x4*)(SC + off + bj * 128), c0, c1);
#pragma unroll
                    for (int j = 0; j < 4; ++j) { acc[ai][bj][m][0][j] *= a0[j] * __builtin_amdgcn_rcpf(fmaxf(c0[j], 1e-30f)); acc[ai][bj][m][1][j] *= a1[j] * __builtin_amdgcn_rcpf(fmaxf(c1[j], 1e-30f)); } }
                asm volatile("" ::: "memory"); }
    }
    __device__ __forceinline__ void operator()(const f32x4 (&acc)[2][2][4][2], const Unit& u, int wr, int wc, int fr, int fq, const LAS float*) const {
        const bf16_t* SC = (const bf16_t*)(ws + WS_SC); bf16_t* MG = (bf16_t*)(ws + WS_MG);
#pragma unroll
        for (int ai = 0; ai < 2; ++ai)
#pragma unroll
            for (int m = 0; m < 4; ++m) { const size_t off = (size_t)(u.pm * 256 + ai * 128 + wr * 64 + m * 16 + fr) * D + u.pn * 256 + wc * 32 + 8 * fq;
#pragma unroll
                for (int bj = 0; bj < 2; ++bj) { f32x4 c0, c1; unpk8(*(const u32x4*)(SC + off + bj * 128), c0, c1);
                    *(u32x4*)(MG + off + bj * 128) = pk8(acc[ai][bj][m][0] * c0, acc[ai][bj][m][1] * c1); }
                asm volatile("" ::: "memory"); }
    }
};

#define XB_TMO      128
#define XB_XCNT(j)  (256  + 64 * (j))
#define XB_XSUB(j)  (1280 + 64 * (j))
#define XB_XGEN(j)  (2304 + 64 * (j))
#define XB_TOP      3328
#define XB_TOPGEN   3392
#define XCD_BAR_WORDS 3456
#define XB_SPIN_CAP (1u << 18)
__device__ __forceinline__ unsigned xb_ld(unsigned* p)              { return __hip_atomic_load(p, __ATOMIC_RELAXED, __HIP_MEMORY_SCOPE_AGENT); }
__device__ __forceinline__ unsigned xb_add(unsigned* p, unsigned v) { return __hip_atomic_fetch_add(p, v, __ATOMIC_RELAXED, __HIP_MEMORY_SCOPE_AGENT); }
__device__ __forceinline__ unsigned xb_xcc_id() { return (unsigned)__builtin_amdgcn_s_getreg((3 << 11) | 20) & 0xFu; }
#define XB_SPIN(cond, bar) do { unsigned _sp = 0; while (cond) { __builtin_amdgcn_s_sleep(1); \
    if ((++_sp & 255u) == 0u) { if (xb_ld(&(bar)[XB_TMO])) break; if (_sp > XB_SPIN_CAP) { atomicAdd(&(bar)[XB_TMO], 1u); break; } } } } while (0)
struct XcdBarrier { unsigned* bar; unsigned x; volatile LAS unsigned* st; };
__device__ __forceinline__ XcdBarrier xcd_barrier_post(unsigned* bar, volatile LAS unsigned* st) {
    XcdBarrier b; b.bar = bar; b.x = xb_xcc_id(); b.st = st;
    if (threadIdx.x == 0) (void)xb_add(&bar[XB_XCNT(b.x)], 1u);
    return b;
}
__device__ __forceinline__ void xcd_barrier_complete(unsigned* bar, unsigned x, unsigned& nloc, unsigned& nx) {
    const unsigned G = gridDim.x * gridDim.y * gridDim.z;
    unsigned sum, cnt, mine, sp = 0u;
    for (;;) {
        sum = 0u; cnt = 0u; mine = 0u;
#pragma unroll
        for (unsigned j = 0; j < 16; ++j) { const unsigned c = xb_ld(&bar[XB_XCNT(j)]); sum += c; cnt += (c > 0u) ? 1u : 0u; }
        mine = xb_ld(&bar[XB_XCNT(x)]);
        if (sum == G) break;
        __builtin_amdgcn_s_sleep(1);
        if ((++sp & 255u) == 0u) { if (xb_ld(&bar[XB_TMO])) break; if (sp > XB_SPIN_CAP) { atomicAdd(&bar[XB_TMO], 1u); break; } }
    }
    nloc = mine > 0u ? mine : 1u; nx = cnt > 0u ? cnt : 1u;
}
template <bool FIRST = false> __device__ __forceinline__ void xcd_barrier(const XcdBarrier& b) {
    asm volatile("s_waitcnt vmcnt(0)" ::: "memory");
    __syncthreads();
    if (threadIdx.x == 0) {
        unsigned* bar = b.bar;
        __builtin_amdgcn_s_waitcnt(0);
        unsigned nloc = b.st[0], nx = b.st[1];
        if constexpr (FIRST) { if (nloc == 0u) { xcd_barrier_complete(bar, b.x, nloc, nx); b.st[0] = nloc; b.st[1] = nx; } }
        else { nloc = nloc ? nloc : 1u; nx = nx ? nx : 1u; }
        const unsigned old = xb_add(&bar[XB_XSUB(b.x)], 1u);
        const unsigned gen = old / nloc;
        if (old + 1u == (gen + 1u) * nloc) {
            __builtin_amdgcn_fence(__ATOMIC_RELEASE, "agent");
            asm volatile("s_waitcnt vmcnt(0)" ::: "memory");
            const unsigned og = xb_add(&bar[XB_TOP], 1u);
            const unsigned tg = og / nx;
            if (og + 1u == (tg + 1u) * nx) xb_add(&bar[XB_TOPGEN], 1u);
            else XB_SPIN(xb_ld(&bar[XB_TOPGEN]) == tg, bar);
            __builtin_amdgcn_fence(__ATOMIC_ACQUIRE, "agent");
            xb_add(&bar[XB_XGEN(b.x)], 1u);
            asm volatile("s_waitcnt vmcnt(0)" ::: "memory");
        } else {
            XB_SPIN(xb_ld(&bar[XB_XGEN(b.x)]) == gen, bar);
            __builtin_amdgcn_fence(__ATOMIC_ACQUIRE, "agent");
            asm volatile("s_waitcnt vmcnt(0)" ::: "memory");
        }
    }
    __syncthreads();
}

struct Args {
    const float *x_prompt, *x_sample, *cache_k, *cache_v, *state_conv, *ln_g, *ln_b, *w_in, *sinks, *conv_w, *wba, *wbc, *w_out, *f1gu, *f1dn, *f2gu, *f2dn;
    float* out; unsigned char* ws;
};

__device__ __forceinline__ int gu_map(int n0) { if (n0 < DFF) return 256 * (n0 >> 7) + (n0 & 127); const int c = n0 - DFF; return 256 * (c >> 7) + 128 + (c & 127); }
__device__ __forceinline__ int in_map(int n0) {
    if (n0 < 1280) { const int hh = n0 >> 6, half = (n0 >> 5) & 1; return 256 * (hh >> 2) + 128 * half + 32 * (hh & 3); }
    if (n0 < 2560) return n0;
    if (n0 < 3584) { const int c = n0 - 2560; return 2560 + 256 * (c >> 7) + (c & 127); }
    if (n0 < 4608) { const int c = n0 - 3584; return 2560 + 256 * (c >> 7) + 128 + (c & 127); }
    return n0;
}
__device__ __forceinline__ unsigned short f2bf_rne(float f) { unsigned u = __float_as_uint(f); u += 0x7fffu + ((u >> 16) & 1u); return (unsigned short)(u >> 16); }
__device__ __forceinline__ void conv_item(const float* W, int Nsrc, int k0, int n0, bf16_t* dst, int dstK, int koff, int drow0, const float* gain, const float* bias, float* part, LAS float* scr, int lane) {
#pragma unroll 8
    for (int i = 0; i < 32; ++i) { const int kk = 2 * i + (lane >> 5); scr[kk * 33 + (lane & 31)] = W[(size_t)(k0 + kk) * Nsrc + n0 + (lane & 31)]; }
    asm volatile("s_waitcnt lgkmcnt(0)" ::: "memory");
    const int c = lane & 7;
    float gk[8], bk[8];
#pragma unroll
    for (int i = 0; i < 8; ++i) { gk[i] = gain ? gain[k0 + 8 * c + i] : 1.f; bk[i] = gain ? bias[k0 + 8 * c + i] : 0.f; }
#pragma unroll
    for (int j = 0; j < 4; ++j) { const int n = (lane >> 3) + 8 * j; const LAS float* s = scr + (8 * c) * 33 + n;
        float w[8]; float p1 = 0.f, p2 = 0.f;
#pragma unroll
        for (int i = 0; i < 8; ++i) { const float v = s[i * 33]; const unsigned short h = f2bf_rne(v * gk[i]); w[i] = __uint_as_float((unsigned)h << 16); p1 += w[i]; p2 += bk[i] * v; }
        u32x4 o; o.x = (__float_as_uint(w[0]) >> 16) | (__float_as_uint(w[1]) & 0xffff0000u); o.y = (__float_as_uint(w[2]) >> 16) | (__float_as_uint(w[3]) & 0xffff0000u);
        o.z = (__float_as_uint(w[4]) >> 16) | (__float_as_uint(w[5]) & 0xffff0000u); o.w = (__float_as_uint(w[6]) >> 16) | (__float_as_uint(w[7]) & 0xffff0000u);
        *(u32x4*)(dst + (size_t)(drow0 + n) * dstK + koff + k0 + 8 * c) = o;
        if (gain) { p1 += __shfl_xor(p1, 1); p2 += __shfl_xor(p2, 1); p1 += __shfl_xor(p1, 2); p2 += __shfl_xor(p2, 2); p1 += __shfl_xor(p1, 4); p2 += __shfl_xor(p2, 4);
            if (c == 0) *(f32x2*)(part + (size_t)(drow0 + n) * 2) = (f32x2){p1, p2}; } }
    asm volatile("s_waitcnt lgkmcnt(0)" ::: "memory");
}

constexpr int KS_PITCH = 144, VT_PITCH = 528, ATT_VT_OFF = 256 * KS_PITCH;
__device__ __forceinline__ int crow(int r, int hi) { return (r & 3) + 8 * (r >> 2) + 4 * hi; }
__device__ __forceinline__ void attn_unit(LAS unsigned char* lds, int sample, int b, int nb, int kh, int l, const Args& a, const bf16_t* Qb, const bf16_t* Kb, const bf16_t* Vb, bf16_t* AO) {
    int tid_l = threadIdx.x; asm volatile("" : "+v"(tid_l));
    const int tid = tid_l, wave = __builtin_amdgcn_readfirstlane(tid >> 6), lane = tid & 63, hi = lane >> 5, l32 = lane & 31;
    LAS unsigned char* Ks = lds; LAS unsigned char* VT = lds + ATT_VT_OFF;
    if (!sample) {
        const int t0 = nb * 128 - 128; const size_t rowb = (size_t)b * T;
#pragma unroll
        for (int i = 0; i < 4; ++i) { const int c = tid + 512 * i, key = c >> 3, dch = c & 7; const int t = t0 + key;
            u32x4 v = (u32x4){0u, 0u, 0u, 0u}; if (t >= 0) v = *(const u32x4*)(Kb + (rowb + t) * DKV + kh * 64 + dch * 8);
            *(LAS u32x4*)(Ks + key * KS_PITCH + dch * 16) = v; }
#pragma unroll
        for (int i = 0; i < 4; ++i) { const int c = tid + 512 * i, dch = c >> 8, key = c & 255; const int t = t0 + key;
            u32x4 v = (u32x4){0u, 0u, 0u, 0u}; if (t >= 0) v = *(const u32x4*)(Vb + (rowb + t) * DKV + kh * 64 + dch * 8);
            LAS unsigned short* p = (LAS unsigned short*)(VT + (dch * 8) * VT_PITCH) + key;
            p[0 * (VT_PITCH / 2)] = (unsigned short)(v.x & 0xffffu); p[1 * (VT_PITCH / 2)] = (unsigned short)(v.x >> 16); p[2 * (VT_PITCH / 2)] = (unsigned short)(v.y & 0xffffu); p[3 * (VT_PITCH / 2)] = (unsigned short)(v.y >> 16);
            p[4 * (VT_PITCH / 2)] = (unsigned short)(v.z & 0xffffu); p[5 * (VT_PITCH / 2)] = (unsigned short)(v.z >> 16); p[6 * (VT_PITCH / 2)] = (unsigned short)(v.w & 0xffffu); p[7 * (VT_PITCH / 2)] = (unsigned short)(v.w >> 16); }
    } else {
        for (int c = tid; c < 1280; c += 512) { const int key = c >> 3, dch = c & 7; f32x4 v0 = (f32x4){0.f, 0.f, 0.f, 0.f}, v1 = v0;
            if (key < WIN) { const float* p = a.cache_k + ((((size_t)l * SB + b) * WIN + key) * NKV + kh) * 64 + dch * 8; v0 = *(const f32x4*)p; v1 = *(const f32x4*)(p + 4); }
            u32x4 w = pk8(v0, v1);
            if (key >= WIN && key < WIN + ST) w = *(const u32x4*)(Kb + ((size_t)MP + b * ST + (key - WIN)) * DKV + kh * 64 + dch * 8);
            *(LAS u32x4*)(Ks + key * KS_PITCH + dch * 16) = w; }
        for (int c = tid; c < 1280; c += 512) { const int dch = c / 160, key = c % 160; f32x4 v0 = (f32x4){0.f, 0.f, 0.f, 0.f}, v1 = v0;
            if (key < WIN) { const float* p = a.cache_v + ((((size_t)l * SB + b) * WIN + key) * NKV + kh) * 64 + dch * 8; v0 = *(const f32x4*)p; v1 = *(const f32x4*)(p + 4); }
            u32x4 v = pk8(v0, v1);
            if (key >= WIN && key < WIN + ST) v = *(const u32x4*)(Vb + ((size_t)MP + b * ST + (key - WIN)) * DKV + kh * 64 + dch * 8);
            LAS unsigned short* p = (LAS unsigned short*)(VT + (dch * 8) * VT_PITCH) + key;
            p[0 * (VT_PITCH / 2)] = (unsigned short)(v.x & 0xffffu); p[1 * (VT_PITCH / 2)] = (unsigned short)(v.x >> 16); p[2 * (VT_PITCH / 2)] = (unsigned short)(v.y & 0xffffu); p[3 * (VT_PITCH / 2)] = (unsigned short)(v.y >> 16);
            p[4 * (VT_PITCH / 2)] = (unsigned short)(v.z & 0xffffu); p[5 * (VT_PITCH / 2)] = (unsigned short)(v.z >> 16); p[6 * (VT_PITCH / 2)] = (unsigned short)(v.w & 0xffffu); p[7 * (VT_PITCH / 2)] = (unsigned short)(v.w >> 16); }
    }
    __syncthreads();
    const int nsub = sample ? (wave < 4 ? 1 : 0) : 2;
    const int g = sample ? (wave & 3) : (wave >> 1), h = kh * 4 + g;
    const float sink = a.sinks[l * NH + h];
    for (int sub = 0; sub < nsub; ++sub) {
        const int r0 = sample ? 0 : (wave & 1) * 64 + sub * 32, r = r0 + l32;
        const size_t qrow = sample ? (size_t)MP + b * ST + (l32 < ST ? l32 : ST - 1) : (size_t)b * T + nb * 128 + r;
        const bool qvalid = sample ? (l32 < ST) : true;
        bf16x8 qf[4];
#pragma unroll
        for (int kk = 0; kk < 4; ++kk) qf[kk] = *(const bf16x8*)(Qb + qrow * DQ + h * 64 + kk * 16 + hi * 8);
        const int kt0 = r0 >> 5;
        f32x16 s[5];
#pragma unroll
        for (int tt = 0; tt < 5; ++tt) {
            f32x16 z; for (int i = 0; i < 16; ++i) z[i] = 0.f;
#pragma unroll
            for (int kk = 0; kk < 4; ++kk) { const bf16x8 kf = *(const LAS bf16x8*)(Ks + ((kt0 + tt) * 32 + l32) * KS_PITCH + (kk * 16 + hi * 8) * 2);
                z = __builtin_amdgcn_mfma_f32_32x32x16_bf16(kf, qf[kk], z, 0, 0, 0); }
            s[tt] = z; __builtin_amdgcn_sched_barrier(0); }
        float mx = sink;
#pragma unroll
        for (int tt = 0; tt < 5; ++tt)
#pragma unroll
            for (int i = 0; i < 16; ++i) { const int j = (kt0 + tt) * 32 + crow(i, hi);
                const bool ok = (j >= r) && (j <= r + WIN) && (sample || nb > 0 || j >= 128);
                const float v = ok ? s[tt][i] : -1e30f; s[tt][i] = v; mx = fmaxf(mx, v); }
        mx = fmaxf(mx, __shfl_xor(mx, 32));
        float sum = 0.f;
#pragma unroll
        for (int tt = 0; tt < 5; ++tt)
#pragma unroll
            for (int i = 0; i < 16; ++i) { const float p = __expf(s[tt][i] - mx); s[tt][i] = p; sum += p; }
        sum += __shfl_xor(sum, 32);
        const float inv = 1.f / (sum + __expf(sink - mx));
        f32x16 o[2];
#pragma unroll
        for (int dt = 0; dt < 2; ++dt) for (int i = 0; i < 16; ++i) o[dt][i] = 0.f;
#pragma unroll
        for (int tt = 0; tt < 5; ++tt)
#pragma unroll
            for (int st = 0; st < 2; ++st) {
                u32x4 pw; pw.x = pk2(s[tt][8 * st + 0], s[tt][8 * st + 1]); pw.y = pk2(s[tt][8 * st + 2], s[tt][8 * st + 3]); pw.z = pk2(s[tt][8 * st + 4], s[tt][8 * st + 5]); pw.w = pk2(s[tt][8 * st + 6], s[tt][8 * st + 7]);
                const bf16x8 pb = __builtin_bit_cast(bf16x8, pw);
#pragma unroll
                for (int dt = 0; dt < 2; ++dt) { const LAS unsigned char* vp = VT + (dt * 32 + l32) * VT_PITCH + ((kt0 + tt) * 32 + 16 * st + 4 * hi) * 2;
                    const u32x2 lo = *(const LAS u32x2*)vp, hi2 = *(const LAS u32x2*)(vp + 16);
                    const u32x4 vw = (u32x4){lo.x, lo.y, hi2.x, hi2.y};
                    o[dt] = __builtin_amdgcn_mfma_f32_32x32x16_bf16(__builtin_bit_cast(bf16x8, vw), pb, o[dt], 0, 0, 0); }
                __builtin_amdgcn_sched_barrier(0); }
        if (qvalid) {
#pragma unroll
            for (int dt = 0; dt < 2; ++dt)
#pragma unroll
                for (int gq = 0; gq < 4; ++gq) { u32x2 w; w.x = pk2(o[dt][4 * gq] * inv, o[dt][4 * gq + 1] * inv); w.y = pk2(o[dt][4 * gq + 2] * inv, o[dt][4 * gq + 3] * inv);
                    *(u32x2*)(AO + qrow * D + h * 64 + dt * 32 + 8 * gq + 4 * hi) = w; } }
    }
    __syncthreads();
}

#ifndef PHM
#define PHM 0xFFF
#endif
constexpr int LDS_TAB_OFF = pg8::STAGE_BYTES, LDS_MISC_OFF = LDS_TAB_OFF + 4096, LDS_BYTES = 147456;
__global__ void __launch_bounds__(512, 2) mega_fwd(Args a) {
    extern __shared__ __attribute__((aligned(16))) unsigned char lds_raw[];
    LAS unsigned char* lds = (LAS unsigned char*)lds_raw;
    const int G = gridDim.x, bx = blockIdx.x;
#define LOCAL_IDS() int tid = threadIdx.x; asm volatile("" : "+v"(tid)); const int lane = tid & 63, wave = __builtin_amdgcn_readfirstlane(tid >> 6); const int gw = bx * 8 + wave, NGW = G * 8; \
    const size_t gt = (size_t)bx * 512 + tid, NGT = (size_t)G * 512; (void)lane; (void)gw; (void)NGW; (void)gt; (void)NGT
    unsigned char* ws = a.ws;
    volatile LAS unsigned* misc = (volatile LAS unsigned*)(lds + LDS_MISC_OFF);
    if (threadIdx.x < 64) misc[threadIdx.x] = 0u;
    __syncthreads();
    XcdBarrier bar = xcd_barrier_post((unsigned*)(ws + WS_CTL) + CW_BAR, misc + 8);
    float* Y = (float*)(ws + WS_Y); bf16_t* YB = (bf16_t*)(ws + WS_YB); bf16_t* ACT = (bf16_t*)(ws + WS_ACT);
    bf16_t *Qb = (bf16_t*)(ws + WS_Q), *Kb = (bf16_t*)(ws + WS_K), *Vb = (bf16_t*)(ws + WS_V), *CB = (bf16_t*)(ws + WS_CB), *U = (bf16_t*)(ws + WS_U);
    bf16_t *SA = (bf16_t*)(ws + WS_SA), *SC = (bf16_t*)(ws + WS_SC), *AO = (bf16_t*)(ws + WS_AO), *MG = (bf16_t*)(ws + WS_MG);
    float* C1 = (float*)(ws + WS_C1); float* C2 = (float*)(ws + WS_C2); float* PART = (float*)(ws + WS_PART); float* ROPE = (float*)(ws + WS_ROPE);
    float* SLOT[2] = {(float*)(ws + WS_SLOT0), (float*)(ws + WS_SLOT1)};

    if (PHM & 1) {
        LOCAL_IDS();
        LAS float* scr = (LAS float*)(lds + wave * 16384);
        constexpr int IT[9] = {0, 11264, 16896, 25600, 26624, 27648, 29696, 40960, 46592};
        for (int it = gw; it < DEPTH * IT[8]; it += NGW) {
            const int l = it / IT[8]; int r = it % IT[8];
            unsigned char* wl = ws + WS_W + (size_t)l * WL_BYTES;
            const float* W; int Nsrc, dstK, koff = 0, mapk = 0, fold = -1, cv = 0; bf16_t* dst;
            if (r < IT[1]) { W = a.f1gu + (size_t)l * D * NGU; Nsrc = NGU; dst = (bf16_t*)(wl + WL_GU1); dstK = D; mapk = 1; fold = l > 0 ? (l - 1) * 3 + 2 : -1; cv = CV_GU1; }
            else if (r < IT[2]) { r -= IT[1]; W = a.f1dn + (size_t)l * DFF * D; Nsrc = D; dst = (bf16_t*)(wl + WL_DN1); dstK = DFF; }
            else if (r < IT[3]) { r -= IT[2]; W = a.w_in + (size_t)l * D * NIN; Nsrc = NIN; dst = (bf16_t*)(wl + WL_IN); dstK = D; mapk = 2; fold = l * 3; cv = CV_IN; }
            else if (r < IT[4]) { r -= IT[3]; W = a.wba + (size_t)l * DQ * D; Nsrc = D; dst = (bf16_t*)(wl + WL_BR); dstK = D; }
            else if (r < IT[5]) { r -= IT[4]; W = a.wbc + (size_t)l * DC * D; Nsrc = D; dst = (bf16_t*)(wl + WL_BR); dstK = D; koff = DQ; }
            else if (r < IT[6]) { r -= IT[5]; W = a.w_out + (size_t)l * D * D; Nsrc = D; dst = (bf16_t*)(wl + WL_OUT); dstK = D; }
            else if (r < IT[7]) { r -= IT[6]; W = a.f2gu + (size_t)l * D * NGU; Nsrc = NGU; dst = (bf16_t*)(wl + WL_GU2); dstK = D; mapk = 1; fold = l * 3 + 1; cv = CV_GU2; }
            else { r -= IT[7]; W = a.f2dn + (size_t)l * DFF * D; Nsrc = D; dst = (bf16_t*)(wl + WL_DN2); dstK = DFF; }
            const int nblk = Nsrc / 32, kb = r / nblk, n0 = (r % nblk) * 32;
            const int drow0 = mapk == 1 ? gu_map(n0) : (mapk == 2 ? in_map(n0) : n0);
            const float* gain = fold >= 0 ? a.ln_g + (size_t)fold * D : nullptr; const float* bias = fold >= 0 ? a.ln_b + (size_t)fold * D : nullptr;
            float* part = PART + (((size_t)l * 32 + kb) * NCV + cv) * 2;
            conv_item(W, Nsrc, kb * 64, n0, dst, dstK, koff, drow0, gain, bias, part, scr, lane);
        }
        for (size_t i = gt; i < (size_t)MPAD * D / 4; i += NGT) { const size_t e = i * 4; f32x4 v = (f32x4){0.f, 0.f, 0.f, 0.f};
            if (e < (size_t)MP * D) v = *(const f32x4*)(a.x_prompt + e); else if (e < (size_t)M * D) v = *(const f32x4*)(a.x_sample + (e - (size_t)MP * D));
            *(f32x4*)(Y + e) = v; u32x2 w; w.x = pk2(v[0], v[1]); w.y = pk2(v[2], v[3]); *(u32x2*)(YB + e) = w; }
        for (size_t i = gt; i < (size_t)(T + ST) * 32; i += NGT) { const int p = (int)(i >> 5), d = (int)(i & 31); const int pos = p < T ? p : PAST + (p - T);
            const float inv = powf(10000.f, -(float)(2 * d) / 64.f); const float ang = (float)pos * inv; ROPE[(size_t)p * 64 + d] = cosf(ang); ROPE[(size_t)p * 64 + 32 + d] = sinf(ang); }
        { const size_t per = (size_t)(WIN - ST) * DKV / 4;
          for (size_t i = gt; i < (size_t)DEPTH * SB * per; i += NGT) { const size_t lb = i / per, e = (i % per) * 4; const size_t src = (lb * WIN + ST) * DKV + e, dst = lb * WIN * DKV + e;
              *(f32x4*)(a.out + O_KS + dst) = *(const f32x4*)(a.cache_k + src); *(f32x4*)(a.out + O_VS + dst) = *(const f32x4*)(a.cache_v + src); } }
    }
    xcd_barrier<true>(bar);
    { LOCAL_IDS();
    for (size_t i = gt; i < (size_t)DEPTH * NCV; i += NGT) { const int l = (int)(i / NCV), col = (int)(i % NCV); float s1 = 0.f, s2 = 0.f;
        if (!(l == 0 && col < NGU)) { for (int kb = 0; kb < 32; ++kb) { const f32x2 p = *(const f32x2*)(PART + (((size_t)l * 32 + kb) * NCV + col) * 2); s1 += p[0]; s2 += p[1]; } }
        C1[i] = s1; C2[i] = s2; } }

    int lnpar = 0;
    for (int l = 0; l < DEPTH; ++l) {
        unsigned char* wl = ws + WS_W + (size_t)l * WL_BYTES;
        const int ident0 = (l == 0);
#pragma unroll 1
        for (int half = 0; half < 2; ++half) {
            if (half == 1) {
                if (PHM & 2) { pg8::Gemm g{YB, (const bf16_t*)(wl + WL_IN), MPAD, NIN, D}; pg8::StaticOrder S; S.init(MPAD, NIN, G, bx);
                  EpiIn E{ws, a.out, l, lnpar};
                  pg8::gemm_phase<EpiIn, pg8::StaticOrder>(lds, g, S, E); }
                xcd_barrier(bar);
                if (PHM & 4) { attn_unit(lds, 0, bx >> 6, (bx >> 2) & 15, bx & 3, l, a, Qb, Kb, Vb, AO);
                  if (bx < SB * NKV) attn_unit(lds, 1, bx >> 2, 0, bx & 3, l, a, Qb, Kb, Vb, AO);
                  const float* cw = a.conv_w + (size_t)l * 3 * DC; LOCAL_IDS();
                  for (size_t i = gt; i < (size_t)M * (DC / 8); i += NGT) { const int m = (int)(i >> 7), c = (int)(i & 127) * 8;
                      f32x4 u0a, u0b, u1a = (f32x4){0.f, 0.f, 0.f, 0.f}, u1b = u1a, u2a = u1a, u2b = u1a, ca, cb2;
                      unpk8(*(const u32x4*)(U + (size_t)m * DC + c), u0a, u0b); unpk8(*(const u32x4*)(CB + (size_t)m * DC + c), ca, cb2);
                      if (m < MP) { const int t = m & (T - 1);
                          if (t >= 1) unpk8(*(const u32x4*)(U + (size_t)(m - 1) * DC + c), u1a, u1b);
                          if (t >= 2) unpk8(*(const u32x4*)(U + (size_t)(m - 2) * DC + c), u2a, u2b); }
                      else { const int bb = (m - MP) >> 2, s = (m - MP) & 3; const float* st = a.state_conv + ((size_t)l * SB + bb) * 2 * DC + c;
                          if (s >= 1) unpk8(*(const u32x4*)(U + (size_t)(m - 1) * DC + c), u1a, u1b); else { u1a = *(const f32x4*)(st + DC); u1b = *(const f32x4*)(st + DC + 4); }
                          if (s >= 2) unpk8(*(const u32x4*)(U + (size_t)(m - 2) * DC + c), u2a, u2b); else { u2a = *(const f32x4*)(st + s * DC); u2b = *(const f32x4*)(st + s * DC + 4); } }
                      const f32x4 w0a = *(const f32x4*)(cw + c), w0b = *(const f32x4*)(cw + c + 4), w1a = *(const f32x4*)(cw + DC + c), w1b = *(const f32x4*)(cw + DC + c + 4), w2a = *(const f32x4*)(cw + 2 * DC + c), w2b = *(const f32x4*)(cw + 2 * DC + c + 4);
                      const f32x4 ya = ca * (w0a * u2a + w1a * u1a + w2a * u0a), yb2 = cb2 * (w0b * u2b + w1b * u1b + w2b * u0b);
                      *(u32x4*)(AO + (size_t)m * D + DQ + c) = pk8(ya, yb2); }
                }
                xcd_barrier(bar);
                if (PHM & 8) { pg8::Gemm g{AO, (const bf16_t*)(wl + WL_BR), MPAD, D, D}; pg8::StaticOrder S; S.init(MPAD, D, G, bx);
                  EpiBr E{ws};
                  pg8::gemm_phase<EpiBr, pg8::StaticOrder>(lds, g, S, E); }
                xcd_barrier(bar);
                if (PHM & 16) { pg8::Gemm g{MG, (const bf16_t*)(wl + WL_OUT), MPAD, D, D}; pg8::StaticOrder S; S.init(MPAD, D, G, bx);
                  EpiRes E{ws, a.ln_g + (size_t)(l * 3) * D, a.ln_b + (size_t)(l * 3) * D, 1.0f, lnpar, 0};
                  pg8::gemm_phase<EpiRes, pg8::StaticOrder>(lds, g, S, E); }
                lnpar ^= 1;
                xcd_barrier(bar);
            }
            if (PHM & 32) { const int ident = (half == 0) ? ident0 : 0; const int cv = half == 0 ? CV_GU1 : CV_GU2;
              pg8::Gemm g{YB, (const bf16_t*)(wl + (half == 0 ? WL_GU1 : WL_GU2)), MPAD, NGU, D}; pg8::StaticOrder S; S.init(MPAD, NGU, G, bx);
              EpiGU E{ws, l * NCV + cv, lnpar, ident};
              pg8::gemm_phase<EpiGU, pg8::StaticOrder>(lds, g, S, E); }
            xcd_barrier(bar);
            if (PHM & 64) { const int ident = (half == 0) ? ident0 : 0; const int lnprev = half == 0 ? (l - 1) * 3 + 2 : l * 3 + 1;
              pg8::Gemm g{ACT, (const bf16_t*)(wl + (half == 0 ? WL_DN1 : WL_DN2)), MPAD, D, DFF}; pg8::StaticOrder S; S.init(MPAD, D, G, bx);
              EpiRes E{ws, a.ln_g + (size_t)(ident ? 0 : lnprev) * D, a.ln_b + (size_t)(ident ? 0 : lnprev) * D, 0.5f, lnpar, ident};
              pg8::gemm_phase<EpiRes, pg8::StaticOrder>(lds, g, S, E); }
            lnpar ^= 1;
            xcd_barrier(bar);
        }
    }
    if (PHM & 128) { LOCAL_IDS(); const float* gl = a.ln_g + (size_t)((DEPTH - 1) * 3 + 2) * D; const float* bl = a.ln_b + (size_t)((DEPTH - 1) * 3 + 2) * D; const float* sl = SLOT[lnpar];
      for (int m = gw; m < M; m += NGW) {
          float s = 0.f, q = 0.f; if (lane < 32) { const f32x2 p = *(const f32x2*)(sl + ((size_t)m * 32 + lane) * 2); s = p[0]; q = p[1]; }
#pragma unroll
          for (int o = 1; o < 32; o <<= 1) { s += __shfl_xor(s, o); q += __shfl_xor(q, o); }
          s = __shfl(s, 0); q = __shfl(q, 0);
          const float mu = s * (1.f / D); float var = q * (1.f / D) - mu * mu; var = var < 0.f ? 0.f : var; const float rstd = 1.f / sqrtf(var + LN_EPS);
          float* op = a.out + (m < MP ? O_YP + (size_t)m * D : O_YS + (size_t)(m - MP) * D);
#pragma unroll
          for (int j = 0; j < 8; ++j) { const int c = (lane + 64 * j) * 4; const f32x4 v = *(const f32x4*)(Y + (size_t)m * D + c);
              *(f32x4*)(op + c) = (v - mu) * rstd * *(const f32x4*)(gl + c) + *(const f32x4*)(bl + c); } }
    }
}

extern "C" void kernel_launch(void* const* d_in, const int* in_sizes, int n_in, void* d_out, int out_size, void* d_ws, size_t ws_size, hipStream_t stream) {
    static int grid = 0;
    if (grid == 0) {
        if (n_in != 17 || (size_t)out_size != O_END || ws_size < WS_END) { fprintf(stderr, "kernel_launch: unexpected sizes: n_in %d out %d ws %zu (need %zu)\n", n_in, out_size, ws_size, (size_t)WS_END); grid = -1; return; }
        int dev = 0, cus = 0, per_cu = 0;
        if (hipGetDevice(&dev) != hipSuccess || hipDeviceGetAttribute(&cus, hipDeviceAttributeMultiprocessorCount, dev) != hipSuccess) { grid = -1; return; }
        if (hipFuncSetAttribute((const void*)mega_fwd, hipFuncAttributeMaxDynamicSharedMemorySize, LDS_BYTES) != hipSuccess) { fprintf(stderr, "kernel_launch: hipFuncSetAttribute failed\n"); grid = -1; return; }
        if (hipOccupancyMaxActiveBlocksPerMultiprocessor(&per_cu, (const void*)mega_fwd, 512, LDS_BYTES) != hipSuccess || per_cu < 1) { fprintf(stderr, "kernel_launch: occupancy query says %d\n", per_cu); }
        (void)hipGetLastError();
        grid = cus;
        if (grid != 256) fprintf(stderr, "kernel_launch: %d CUs (the attention phase assumes 256 workgroups)\n", grid);
    }
    if (grid < 0) return;
    (void)hipMemsetAsync((char*)d_ws + WS_CTL, 0, CTL_ZERO_BYTES, stream);
    Args a{};
    a.x_prompt = (const float*)d_in[0]; a.x_sample = (const float*)d_in[1]; a.cache_k = (const float*)d_in[2]; a.cache_v = (const float*)d_in[3]; a.state_conv = (const float*)d_in[4];
    a.ln_g = (const float*)d_in[5]; a.ln_b = (const float*)d_in[6]; a.w_in = (const float*)d_in[7]; a.sinks = (const float*)d_in[8]; a.conv_w = (const float*)d_in[9];
    a.wba = (const float*)d_in[10]; a.wbc = (const float*)d_in[11]; a.w_out = (const float*)d_in[12]; a.f1gu = (const float*)d_in[13]; a.f1dn = (const float*)d_in[14];
    a.f2gu = (const float*)d_in[15]; a.f2dn = (const float*)d_in[16]; a.out = (float*)d_out; a.ws = (unsigned char*)d_ws;
    hipLaunchKernelGGL(mega_fwd, dim3(grid), dim3(512), LDS_BYTES, stream, a);
    const hipError_t le = hipPeekAtLastError();
    if (le != hipSuccess) fprintf(stderr, "kernel_launch: launch failed: %s\n", hipGetErrorName(le));
}
```
